# Optimizing an MI355X kernel written in HIP

```python
import math
import jax, jax.numpy as jnp
from jax import lax
import numpy as np

D_MODEL = 2048
BATCH = 16
SEQ = 2048
DEPTH = 1

RET_HEADS = 8
RET_DK = 128
RET_DV = 128
RET_WIDTH = RET_HEADS * RET_DV
RET_CHUNK = 128

NSA_HEADS = 8
NSA_GROUPS = 2
NSA_HD = 128
NSA_WIDTH = NSA_HEADS * NSA_HD
NSA_KV_WIDTH = NSA_GROUPS * NSA_HD
CMP_BLOCK = 32
CMP_STRIDE = 16
CMP_HIDDEN = 256
SEL_BLOCK = 64
SEL_TOPN = 16
SEL_QBLK = 32
WINDOW = 512
WIN_QBLK = 128
FORCE_BONUS = 1.0e4

ROPE_THETA = 10000.0
EPS = 1e-6
NEG = -1.0e30

IN_SPLITS = (RET_HEADS * RET_DK, RET_HEADS * RET_DK, RET_WIDTH, RET_WIDTH,
             NSA_WIDTH, NSA_KV_WIDTH, NSA_KV_WIDTH, NSA_KV_WIDTH, NSA_KV_WIDTH,
             NSA_KV_WIDTH, NSA_KV_WIDTH, NSA_WIDTH, NSA_HEADS * 3, D_MODEL, D_MODEL)
IN_WIDTH = sum(IN_SPLITS)

kernel_name = "gated_parallel_retention_nsa_block"


def rmsnorm(x, g):
    xf = x.astype(jnp.float32)
    y = xf * lax.rsqrt(jnp.mean(xf * xf, -1, keepdims=True) + EPS)
    return (y * g.astype(jnp.float32)).astype(x.dtype)


def rope_tables(pos, hd):
    inv = jnp.exp(jnp.arange(0, hd, 2, dtype=jnp.float32) * (-math.log(ROPE_THETA) / hd))
    ang = pos.astype(jnp.float32)[..., None] * inv
    ang = jnp.concatenate([ang, ang], -1)[:, None]
    return jnp.cos(ang), jnp.sin(ang)


def apply_rope(x, cos, sin):
    xf = x.astype(jnp.float32)
    half = xf.shape[-1] // 2
    rot = jnp.concatenate([-xf[..., half:], xf[..., :half]], -1)
    return (xf * cos + rot * sin).astype(x.dtype)


def heads(t, n):
    B, S, W = t.shape
    return t.reshape(B, S, n, W // n).transpose(0, 2, 1, 3)


def retention(q, k, v, g):
    f32 = jnp.float32
    B, H, S, DK = q.shape
    DV = v.shape[-1]
    C = RET_CHUNK
    N = S // C
    log_gamma = jnp.log1p(-jnp.exp2(-5.0 - jnp.arange(H, dtype=f32)))
    idx = jnp.arange(C, dtype=f32)
    diff = idx[:, None] - idx[None, :]
    dmask = jnp.where(diff >= 0, jnp.exp(log_gamma[:, None, None] * jnp.maximum(diff, 0.0)), 0.0)
    zeta = jnp.exp(log_gamma[:, None] * (C - 1 - idx))
    xi = jnp.exp(log_gamma[:, None] * (idx + 1))
    chunk_decay = jnp.exp(log_gamma * C)
    qc = q.astype(f32).reshape(B, H, N, C, DK)
    kc = k.astype(f32).reshape(B, H, N, C, DK) * (DK ** -0.5)
    vc = v.astype(f32).reshape(B, H, N, C, DV)
    sc = jnp.einsum('bhncd,bhnmd->bhncm', qc, kc) * dmask[None, :, None]
    inner = jnp.einsum('bhncm,bhnme->bhnce', sc, vc)
    kv = jnp.einsum('bhnmd,hm,bhnme->bhnde', kc, zeta, vc)

    def step(state, kv_n):
        return state * chunk_decay[None, :, None, None] + kv_n, state

    _, prev = lax.scan(step, jnp.zeros((B, H, DK, DV), f32), jnp.moveaxis(kv, 2, 0))
    prev = jnp.moveaxis(prev, 0, 2)
    cross = jnp.einsum('bhncd,bhnde->bhnce', qc, prev) * xi[None, :, None, :, None]
    o = (inner + cross).reshape(B, H, S, DV)
    mu = jnp.mean(o, -1, keepdims=True)
    var = jnp.mean(jnp.square(o - mu), -1, keepdims=True)
    o = (o - mu) * lax.rsqrt(var + EPS)
    o = o.transpose(0, 2, 1, 3).reshape(B, S, H * DV) * g.astype(f32)
    return o.astype(v.dtype)


def compress_blocks(kraw, cidx, pe, w1, w2):
    B, G, _, hd = kraw.shape
    blk = kraw[:, :, cidx] + pe
    flat = blk.reshape(B, G, cidx.shape[0], CMP_BLOCK * hd)
    return jax.nn.silu(flat @ w1) @ w2


def nsa_attention(q, k_cmp, v_cmp, k_sel, v_sel, k_win, v_win, gates, positions,
                  w_ck1, w_ck2, pe_ck, w_cv1, w_cv2, pe_cv):
    f32 = jnp.float32
    B, H, S, hd = q.shape
    G = k_sel.shape[1]
    R = H // G
    scale = hd ** -0.5
    qg = q.reshape(B, G, R, S, hd)
    t = jnp.arange(S)

    ncmp = (S - CMP_BLOCK) // CMP_STRIDE + 1
    cidx = jnp.arange(ncmp)[:, None] * CMP_STRIDE + jnp.arange(CMP_BLOCK)[None, :]
    cend = cidx[:, -1]
    kc = compress_blocks(k_cmp, cidx, pe_ck, w_ck1, w_ck2)
    vc = compress_blocks(v_cmp, cidx, pe_cv, w_cv1, w_cv2)
    ccos, csin = rope_tables(positions[:, cend], hd)
    kc = apply_rope(kc, ccos, csin)
    s_c = jnp.einsum('bgrtd,bgnd->bgrtn', qg, kc).astype(f32) * scale
    valid_c = cend[None, :] <= t[:, None]
    p_c = jax.nn.softmax(jnp.where(valid_c, s_c, NEG), -1) * valid_c.any(-1)[:, None]
    o_cmp = jnp.einsum('bgrtn,bgnd->bgrtd', p_c.astype(vc.dtype), vc)

    nsel = S // SEL_BLOCK
    topn = min(SEL_TOPN, nsel)
    cstart = jnp.arange(ncmp) * CMP_STRIDE
    sstart = jnp.arange(nsel) * SEL_BLOCK
    overlap = jnp.clip(jnp.minimum(cstart[:, None] + CMP_BLOCK, sstart[None, :] + SEL_BLOCK)
                       - jnp.maximum(cstart[:, None], sstart[None, :]), 0, None).astype(f32) / CMP_BLOCK
    imp = jnp.einsum('bgrtn,nj->bgtj', p_c, overlap)
    tblk = t // SEL_BLOCK
    j = jnp.arange(nsel)
    forced = (j[None, :] == 0) | (j[None, :] == tblk[:, None]) | (j[None, :] == tblk[:, None] - 1)
    causal_b = j[None, :] <= tblk[:, None]
    scores = jnp.where(causal_b, imp + FORCE_BONUS * forced, NEG)
    top_v, top_i = lax.top_k(scores, topn)
    top_ok = top_v > NEG * 0.5
    kb = k_sel.reshape(B, G, nsel, SEL_BLOCK, hd)
    vb = v_sel.reshape(B, G, nsel, SEL_BLOCK, hd)
    nqb = S // SEL_QBLK
    bi = jnp.arange(B)[:, None, None, None]
    gi = jnp.arange(G)[None, :, None, None]

    def sel_block(args):
        qb, ib, okb, tb = args
        kg = kb[bi, gi, ib]
        vg = vb[bi, gi, ib]
        s = jnp.einsum('bgrqd,bgqnkd->bgrqnk', qb, kg).astype(f32) * scale
        kpos = ib[..., None] * SEL_BLOCK + jnp.arange(SEL_BLOCK)
        m = okb[..., None] & (kpos <= tb[None, None, :, None, None])
        s = jnp.where(m[:, :, None], s, NEG)
        p = jax.nn.softmax(s.reshape(s.shape[:4] + (-1,)), -1).reshape(s.shape)
        return jnp.einsum('bgrqnk,bgqnkd->bgrqd', p.astype(vg.dtype), vg)

    xs = (jnp.moveaxis(qg.reshape(B, G, R, nqb, SEL_QBLK, hd), 3, 0),
          jnp.moveaxis(top_i.reshape(B, G, nqb, SEL_QBLK, topn), 2, 0),
          jnp.moveaxis(top_ok.reshape(B, G, nqb, SEL_QBLK, topn), 2, 0),
          t.reshape(nqb, SEL_QBLK))
    o_sel = jnp.moveaxis(lax.map(sel_block, xs), 0, 3).reshape(B, G, R, S, hd)

    nw = S // WIN_QBLK
    span = WINDOW + WIN_QBLK
    widx = jnp.arange(nw)[:, None] * WIN_QBLK + jnp.arange(span)[None, :]
    pad = ((0, 0), (0, 0), (WINDOW, 0), (0, 0))
    kw = jnp.pad(k_win, pad)[:, :, widx]
    vw = jnp.pad(v_win, pad)[:, :, widx]
    qw = qg.reshape(B, G, R, nw, WIN_QBLK, hd)
    s_w = jnp.einsum('bgrnqd,bgnkd->bgrnqk', qw, kw).astype(f32) * scale
    kpos = widx - WINDOW
    qpos = t.reshape(nw, WIN_QBLK)
    d = qpos[:, :, None] - kpos[:, None, :]
    m_w = (kpos[:, None, :] >= 0) & (d >= 0) & (d < WINDOW)
    p_w = jax.nn.softmax(jnp.where(m_w, s_w, NEG), -1)
    o_win = jnp.einsum('bgrnqk,bgnkd->bgrnqd', p_w.astype(vw.dtype), vw).reshape(B, G, R, S, hd)

    gt = gates.reshape(B, S, G, R, 3).transpose(0, 2, 3, 1, 4)
    o = gt[..., 0:1] * o_cmp + gt[..., 1:2] * o_sel + gt[..., 2:3] * o_win
    return o.transpose(0, 3, 1, 2, 4).reshape(B, S, H * hd)


def setup_inputs(seed: int = 0) -> dict:
    key = jax.random.key(seed)
    ks = jax.random.split(key, 18)
    f32 = jnp.float32
    nrm = lambda k, shape, s: jax.random.normal(k, shape, f32) * s
    x = jax.random.normal(ks[0], (BATCH, SEQ, D_MODEL), f32)
    c = jax.random.normal(ks[1], (BATCH, D_MODEL), f32)
    offset = jax.random.randint(ks[2], (BATCH, 1), 0, 4096, dtype=jnp.int32)
    positions = offset + jnp.arange(SEQ, dtype=jnp.int32)[None, :]
    return {
        "x": x,
        "c": c,
        "positions": positions,
        "w_ada": nrm(ks[3], (DEPTH, D_MODEL, 3 * D_MODEL), D_MODEL ** -0.5),
        "b_ada": nrm(ks[4], (DEPTH, 3 * D_MODEL), 0.01),
        "g_norm": 1.0 + nrm(ks[5], (DEPTH, D_MODEL), 0.02),
        "w_in": nrm(ks[6], (DEPTH, D_MODEL, IN_WIDTH), D_MODEL ** -0.5),
        "g_ret": 1.0 + nrm(ks[7], (DEPTH, RET_WIDTH), 0.02),
        "w_ck1": nrm(ks[8], (DEPTH, CMP_BLOCK * NSA_HD, CMP_HIDDEN), (CMP_BLOCK * NSA_HD) ** -0.5),
        "w_ck2": nrm(ks[9], (DEPTH, CMP_HIDDEN, NSA_HD), CMP_HIDDEN ** -0.5),
        "pe_ck": nrm(ks[10], (DEPTH, CMP_BLOCK, NSA_HD), 0.1),
        "w_cv1": nrm(ks[11], (DEPTH, CMP_BLOCK * NSA_HD, CMP_HIDDEN), (CMP_BLOCK * NSA_HD) ** -0.5),
        "w_cv2": nrm(ks[12], (DEPTH, CMP_HIDDEN, NSA_HD), CMP_HIDDEN ** -0.5),
        "pe_cv": nrm(ks[13], (DEPTH, CMP_BLOCK, NSA_HD), 0.1),
        "w_up_ret": nrm(ks[14], (DEPTH, RET_WIDTH, D_MODEL), RET_WIDTH ** -0.5),
        "w_up_nsa": nrm(ks[15], (DEPTH, NSA_WIDTH, D_MODEL), NSA_WIDTH ** -0.5),
        "w_out": nrm(ks[16], (DEPTH, D_MODEL, D_MODEL), D_MODEL ** -0.5),
        "g_final": 1.0 + nrm(ks[17], (D_MODEL,), 0.02),
    }


def reference(x, c, positions, w_ada, b_ada, g_norm, w_in, g_ret, w_ck1, w_ck2, pe_ck,
              w_cv1, w_cv2, pe_cv, w_up_ret, w_up_nsa, w_out, g_final):
    cos, sin = rope_tables(positions, NSA_HD)
    split_at = [int(v) for v in np.cumsum(IN_SPLITS)[:-1]]
    for l in range(DEPTH):
        mod = jax.nn.silu(c) @ w_ada[l] + b_ada[l]
        shift, scl, gate = jnp.split(mod, 3, -1)
        h = rmsnorm(x, g_norm[l]) * (1.0 + scl[:, None]) + shift[:, None]
        (r_q, r_k, r_v, r_g, n_q, n_kc, n_vc, n_ks, n_vs, n_kw, n_vw, n_g, n_bg,
         m_a, m_b) = jnp.split(h @ w_in[l], split_at, -1)
        y_ret = retention(apply_rope(heads(r_q, RET_HEADS), cos, sin),
                          apply_rope(heads(r_k, RET_HEADS), cos, sin),
                          heads(r_v, RET_HEADS), g_ret[l]) * jax.nn.silu(r_g)
        y_nsa = nsa_attention(apply_rope(heads(n_q, NSA_HEADS), cos, sin),
                              heads(n_kc, NSA_GROUPS), heads(n_vc, NSA_GROUPS),
                              apply_rope(heads(n_ks, NSA_GROUPS), cos, sin), heads(n_vs, NSA_GROUPS),
                              apply_rope(heads(n_kw, NSA_GROUPS), cos, sin), heads(n_vw, NSA_GROUPS),
                              jax.nn.sigmoid(n_bg), positions,
                              w_ck1[l], w_ck2[l], pe_ck[l], w_cv1[l], w_cv2[l], pe_cv[l]) * jax.nn.silu(n_g)
        merged = jax.nn.sigmoid(m_a) * (y_ret @ w_up_ret[l]) + jax.nn.sigmoid(m_b) * (y_nsa @ w_up_nsa[l])
        x = x + gate[:, None] * (merged @ w_out[l])
    return rmsnorm(x, g_final)
```

```cpp
#include <hip/hip_runtime.h>
#include <hip/hip_cooperative_groups.h>
#include <hip/hip_bf16.h>
#include <cstdio>
#include <cstdint>
namespace cg = cooperative_groups;

#define LAS __attribute__((address_space(3)))
#define GAS __attribute__((address_space(1)))
typedef unsigned short bf16_t;
typedef short bf16x8 __attribute__((ext_vector_type(8)));
typedef short s16x4 __attribute__((ext_vector_type(4)));
typedef float f32x4 __attribute__((ext_vector_type(4)));
typedef float f32x2 __attribute__((ext_vector_type(2)));
typedef float f32x16 __attribute__((ext_vector_type(16)));
typedef unsigned u32x4 __attribute__((ext_vector_type(4)));
typedef unsigned u32x2 __attribute__((ext_vector_type(2)));
typedef __bf16 bf16x2_t __attribute__((ext_vector_type(2)));

constexpr int BATCH = 16, SEQ = 2048, DM = 2048, MTOK = BATCH * SEQ;
constexpr int NHEAD = 8, HD = 128, NGRP = 2, NREP = 4;
constexpr int IN_W = 11800, IN_WP = 12032;
constexpr int NCMP = 127;
constexpr float EPS = 1e-6f;
constexpr float QSCALE = 0.08838834764831845f * 1.4426950408889634f;
constexpr float KSCALE_RET = 0.08838834764831845f;
constexpr float LN_THETA_OVER_HD = 9.210340371976184f / 128.f;

constexpr size_t MiB = 1u << 20;
constexpr size_t DO_H = 0;
constexpr size_t DO_YRET = 0, DO_YNSA = 64 * MiB;
constexpr size_t DO_WINT = 128 * MiB;
constexpr size_t DO_STATES = 176 * MiB;
constexpr size_t WS_CTL = 0, CTL_BYTES = 1 * MiB;
constexpr size_t WS_WUPR = 1 * MiB, WS_WUPN = 5 * MiB, WS_WOUT = 9 * MiB;
constexpr size_t WS_WCK1 = 17 * MiB, WS_WCV1 = 19 * MiB, WS_WCK2 = 21 * MiB, WS_WCV2 = 21 * MiB + 65536;
constexpr size_t WS_MOD = 21 * MiB + 512 * 1024;
constexpr size_t WS_B1P = 22 * MiB;
constexpr size_t WS_GATES = 23 * MiB;
constexpr size_t WS_ROWSQ = 27 * MiB;
constexpr size_t WS_KCP = 32 * MiB;
constexpr size_t WS_RQ = 48 * MiB, WS_RK = 112 * MiB, WS_RV = 176 * MiB, WS_RG = 240 * MiB, WS_NQ = 304 * MiB, WS_NG = 368 * MiB;
constexpr size_t WS_NKC = 432 * MiB, WS_NVC = 449 * MiB, WS_NKS = 466 * MiB, WS_NVS = 482 * MiB, WS_NKW = 498 * MiB, WS_NVW = 514 * MiB;
constexpr size_t WS_MA = 530 * MiB, WS_MB = 658 * MiB, WS_END = 786 * MiB;
constexpr size_t WS_MERGED = WS_RQ;

constexpr int LDS_BYTES = 147456;
constexpr int NWAVES = 8, NTHREADS = 512;

__device__ __forceinline__ unsigned cvtpk(float lo, float hi) { f32x2 v = {lo, hi}; bf16x2_t b = __builtin_convertvector(v, bf16x2_t); return __builtin_bit_cast(unsigned, b); }
__device__ __forceinline__ float bf_lo(unsigned w) { return __uint_as_float(w << 16); }
__device__ __forceinline__ float bf_hi(unsigned w) { return __uint_as_float(w & 0xffff0000u); }
__device__ __forceinline__ float bf2f(bf16_t b) { return __uint_as_float(((unsigned)b) << 16); }
__device__ __forceinline__ bf16_t f2bf(float f) { return (bf16_t)(cvtpk(f, 0.f) & 0xffffu); }
__device__ __forceinline__ float sigmoidf_(float x) { return __builtin_amdgcn_rcpf(1.f + __builtin_amdgcn_exp2f(-1.4426950408889634f * x)); }
__device__ __forceinline__ float siluf_(float x) { return x * sigmoidf_(x); }
__device__ __forceinline__ float wave_sum(float v) {
#pragma unroll
    for (int o = 1; o < 64; o <<= 1) v += __shfl_xor(v, o);
    return v;
}
__device__ __forceinline__ int lane_id() { int l; asm volatile("v_mbcnt_lo_u32_b32 %0, -1, 0\n\tv_mbcnt_hi_u32_b32 %0, -1, %0" : "=v"(l)); return l; }
#define LDS_WAIT() asm volatile("s_waitcnt lgkmcnt(0)" ::: "memory")
#define VM_WAIT() asm volatile("s_waitcnt vmcnt(0)" ::: "memory")
#define SBAR() __builtin_amdgcn_sched_barrier(0)
__device__ __forceinline__ float rope_inv(int j) { return __expf(-(float)(2 * j) * LN_THETA_OVER_HD); }
__device__ __forceinline__ void sincos_rev(float ang, float& c, float& s) {
    float rev = ang * 0.15915494309189535f; rev = rev - floorf(rev);
    s = __builtin_amdgcn_sinf(rev); c = __builtin_amdgcn_cosf(rev);
}
__device__ __host__ __forceinline__ int rope_pos_of_d(int d) { const int n = d >> 6, wc = (d >> 4) & 3, fq = (d >> 2) & 3, i = d & 3; return 32 * wc + 8 * fq + 4 * n + i; }

namespace pg8 {
constexpr int BM = 256, BK = 64, HALF = 128, HTB = HALF * BK * 2, STAGE_BYTES = 8 * HTB, NXCD = 8, WGM = 8;
__host__ __device__ __forceinline__ int lds_byte(int r, int c) { const int st = (r >> 4) * 2 + (c >> 5), rr = r & 15, cc = c & 31, ob = rr * 64 + cc * 2; return st * 1024 + (ob ^ (((ob >> 9) & 1) << 5)); }
__host__ __device__ __forceinline__ void stage_rc(int b, int& R, int& C) { const int st = b / 1024, sb = b % 1024, swz = sb ^ (((sb >> 9) & 1) << 5); R = (st >> 1) * 16 + swz / 64; C = (st & 1) * 32 + (swz % 64) / 2; }
__host__ __device__ __forceinline__ int perm32(int rho) { const int n = rho >> 4, i = rho & 15; return 8 * (i >> 2) + 4 * n + (i & 3); }

struct Unit { int pm, pn, sel; };
struct Gemm { const bf16_t* A0; const bf16_t* B0; const bf16_t* A1; const bf16_t* B1; int M, N, K; };

template <int NSEL> struct StaticOrder {
    int nM, nN, nwg, G, c;
    __device__ void init(int M, int N, int G_, int c_) { nM = M / BM; nN = N / BM; nwg = nM * nN; G = G_; c = c_; }
    __device__ bool next(int i, Unit& u) const {
        const int it = i / NSEL; u.sel = i - it * NSEL;
        const long L = (long)it * G + c; if (L >= nwg) return false;
        int wgid = (int)L; { const int q = nwg / NXCD, r = nwg % NXCD, xcd = wgid % NXCD, off = wgid / NXCD; wgid = (xcd < r ? xcd * (q + 1) : r * (q + 1) + (xcd - r) * q) + off; }
        const int nig = WGM * nN, gid = wgid / nig, fm = gid * WGM, gsz = (nM - fm) < WGM ? (nM - fm) : WGM;
        u.pm = fm + ((wgid % nig) % gsz); u.pn = (wgid % nig) / gsz; return true;
    }
};

template <class Epi, class Sched>
__device__ __forceinline__ void gemm_phase(LAS unsigned char* lds, const Gemm g, const Sched& S, const Epi& E, int wave_) {
    const int lane = lane_id(), wid = wave_, tid = wid * 64 + lane, wr = wid >> 2, wc = wid & 3, fr = lane & 15, fq = lane >> 4;
    const int K = g.K, nt = K / BK;
    unsigned voffA[2], voffB[2];
#pragma unroll
    for (int i = 0; i < 2; ++i) { int R, C; stage_rc(tid * 16 + i * 8192, R, C); const int Rb = Epi::PERM ? ((R & ~31) + perm32(R & 31)) : R;
        voffA[i] = (unsigned)(R * K + C) * 2u; voffB[i] = (unsigned)(Rb * K + C) * 2u; }
    const size_t kstep = (size_t)(BK * 2);
    const size_t hstep = (size_t)HALF * K * 2;
    const size_t tstep = 2 * hstep;
    const unsigned ldsw = (unsigned)wid * 1024u;
    const int aoff = lds_byte(wr * 64 + fr, fq * 8), boff = lds_byte(wc * 32 + fr, fq * 8);
#define PG8_SA(b, h) (((b) * 2 + (h)) * HTB)
#define PG8_SB(b, h) ((4 + (b) * 2 + (h)) * HTB)
#define PG8_STAGE(bufoff, gbase, voff) do { _Pragma("unroll") for (int _i = 0; _i < 2; ++_i) \
        __builtin_amdgcn_global_load_lds((const unsigned*)((const char*)(gbase) + (voff)[_i]), (LAS unsigned*)(lds + (bufoff) + ldsw + _i * 8192), 16, 0, 0); } while (0)
#define PG8_LDA(dst, b, h) do { _Pragma("unroll") for (int m = 0; m < 4; ++m) _Pragma("unroll") for (int k = 0; k < 2; ++k) dst[m][k] = *(const LAS bf16x8*)(lds + PG8_SA(b, h) + aoff + m * 2048 + k * 1024); } while (0)
#define PG8_LDB(dst, b, h) do { _Pragma("unroll") for (int n = 0; n < 2; ++n) _Pragma("unroll") for (int k = 0; k < 2; ++k) dst[n][k] = *(const LAS bf16x8*)(lds + PG8_SB(b, h) + boff + n * 2048 + k * 1024); } while (0)
#define PG8_MMA(ai, bj, At, Bt) do { __builtin_amdgcn_s_setprio(1); _Pragma("unroll") for (int m = 0; m < 4; ++m) _Pragma("unroll") for (int n = 0; n < 2; ++n) _Pragma("unroll") for (int k = 0; k < 2; ++k) \
        acc[ai][bj][m][n] = __builtin_amdgcn_mfma_f32_16x16x32_bf16(Bt[n][k], At[m][k], acc[ai][bj][m][n], 0, 0, 0); __builtin_amdgcn_s_setprio(0); } while (0)
#define PG8_WAIT_V(n) asm volatile("s_waitcnt vmcnt(" #n ")" ::: "memory")
#define PG8_WAIT_L(n) asm volatile("s_waitcnt lgkmcnt(" #n ")" ::: "memory")
#define PG8_BAR __builtin_amdgcn_s_barrier()
#define PG8_SCHED __builtin_amdgcn_sched_barrier(0)
    Unit cur, nxt; int ui = 0;
    if (!S.next(0, cur)) return;
    f32x4 acc[2][2][4][2];
#pragma unroll
    for (int a = 0; a < 2; ++a)
#pragma unroll
        for (int b = 0; b < 2; ++b)
#pragma unroll
            for (int m = 0; m < 4; ++m)
#pragma unroll
                for (int n = 0; n < 2; ++n) acc[a][b][m][n] = (f32x4){0.f, 0.f, 0.f, 0.f};
    bf16x8 At[4][2], B0[2][2], B1[2][2];
    const char* cA = (const char*)(cur.sel ? g.A1 : g.A0) + (size_t)cur.pm * tstep; const char* cB = (const char*)(cur.sel ? g.B1 : g.B0) + (size_t)cur.pn * tstep;
    PG8_STAGE(PG8_SB(0, 0), cB, voffB); PG8_STAGE(PG8_SB(0, 1), cB + hstep, voffB); PG8_STAGE(PG8_SA(0, 0), cA, voffA); PG8_STAGE(PG8_SA(0, 1), cA + hstep, voffA);
    if (wr == 1) PG8_BAR;
    PG8_WAIT_V(2); PG8_BAR;
    PG8_STAGE(PG8_SB(1, 0), cB + kstep, voffB); PG8_STAGE(PG8_SA(1, 0), cA + kstep, voffA); PG8_STAGE(PG8_SB(1, 1), cB + hstep + kstep, voffB);
    PG8_WAIT_V(6); PG8_BAR;
    for (;;) {
        const bool has_next = S.next(ui + 1, nxt);
        const char* nA = has_next ? (const char*)(nxt.sel ? g.A1 : g.A0) + (size_t)nxt.pm * tstep : cA; const char* nB = has_next ? (const char*)(nxt.sel ? g.B1 : g.B0) + (size_t)nxt.pn * tstep : cB;
        for (int t = 0; t < nt; t += 2) {
            const bool last = (t == nt - 2);
            const char* a1 = cA + (size_t)(t + 1) * kstep;
            const char* a2 = last ? nA : cA + (size_t)(t + 2) * kstep; const char* b2 = last ? nB : cB + (size_t)(t + 2) * kstep;
            const char* a3 = a2 + kstep; const char* b3 = b2 + kstep;
            PG8_LDB(B0, 0, 0); PG8_LDB(B1, 0, 1); PG8_SCHED; PG8_LDA(At, 0, 0); PG8_STAGE(PG8_SA(1, 1), a1 + hstep, voffA);
            PG8_WAIT_V(8); PG8_WAIT_L(0); PG8_BAR; PG8_MMA(0, 0, At, B0); PG8_MMA(0, 1, At, B1); PG8_BAR; PG8_SCHED;
            PG8_LDA(At, 0, 1); PG8_STAGE(PG8_SB(0, 0), b2, voffB); PG8_STAGE(PG8_SB(0, 1), b2 + hstep, voffB); PG8_STAGE(PG8_SA(0, 0), a2, voffA);
            PG8_WAIT_V(8); PG8_WAIT_L(0); PG8_BAR; PG8_MMA(1, 0, At, B0); PG8_MMA(1, 1, At, B1); PG8_BAR; PG8_SCHED;
            PG8_LDB(B0, 1, 0); PG8_LDB(B1, 1, 1); PG8_SCHED; PG8_LDA(At, 1, 0); PG8_STAGE(PG8_SA(0, 1), a2 + hstep, voffA);
            PG8_WAIT_V(8); PG8_WAIT_L(0); PG8_BAR; PG8_MMA(0, 0, At, B0); PG8_MMA(0, 1, At, B1); PG8_BAR; PG8_SCHED;
            PG8_LDA(At, 1, 1); PG8_STAGE(PG8_SB(1, 0), b3, voffB); PG8_STAGE(PG8_SB(1, 1), b3 + hstep, voffB); PG8_STAGE(PG8_SA(1, 0), a3, voffA);
            PG8_WAIT_V(8); PG8_WAIT_L(0); PG8_BAR; PG8_MMA(1, 0, At, B0); PG8_MMA(1, 1, At, B1); PG8_BAR; PG8_SCHED;
        }
        if (wr == 0) PG8_BAR;
        E(acc, cur, wr, wc, fr, fq);
        if (!has_next) break;
        if (!E.keep(cur)) {
#pragma unroll
        for (int a = 0; a < 2; ++a)
#pragma unroll
            for (int b = 0; b < 2; ++b)
#pragma unroll
                for (int m = 0; m < 4; ++m)
#pragma unroll
                    for (int n = 0; n < 2; ++n) acc[a][b][m][n] = (f32x4){0.f, 0.f, 0.f, 0.f};
        }
        cur = nxt; cA = nA; cB = nB; ++ui;
        if (wr == 1) PG8_BAR;
    }
    PG8_WAIT_V(0);
    PG8_BAR;
#undef PG8_SA
#undef PG8_SB
#undef PG8_STAGE
#undef PG8_LDA
#undef PG8_LDB
#undef PG8_MMA
#undef PG8_WAIT_V
#undef PG8_WAIT_L
#undef PG8_BAR
#undef PG8_SCHED
}
}

struct Args { const void* in[18]; float* out; unsigned char* ws; int ph_lo, ph_hi; };
struct Frame {
    LAS unsigned char* lds;
    int wave, G, bid;
    const float *x, *c; const int* pos;
    const float *w_ada, *b_ada, *g_norm, *w_in, *g_ret, *w_ck1, *w_ck2, *pe_ck, *w_cv1, *w_cv2, *pe_cv, *w_up_ret, *w_up_nsa, *w_out, *g_final;
    float* out; unsigned char* ws; unsigned char* dob;
};
#define FLANE() lane_id()
#define FTID() (F.wave * 64 + lane_id())
#define WSP(T, off) ((T*)(F.ws + (off)))
#define DOP(T, off) ((T*)(F.dob + (off)))

struct MapId { __device__ __forceinline__ int operator()(int c) const { return c; } };
struct MapWin {
    __device__ __forceinline__ int operator()(int s) const {
        if (s >= 7704) return s - 24;
        if (s >= 7680) return 11776 + (s - 7680);
        const int pn = s >> 8;
        const bool rope = (pn < 8) || (pn >= 16 && pn < 20) || pn == 22 || pn == 24;
        if (!rope) return s;
        return (s & ~127) + rope_pos_of_d(s & 127);
    }
};
template <class Map>
__device__ __forceinline__ void p0_transpose_item(const float* W, int K, int N, bf16_t* WT, LAS float* scr, int item, int lane, Map map) {
    const int nblk = (N + 31) / 32, kb = item / nblk, nb = item - kb * nblk, k0 = 64 * kb, n0 = 32 * nb;
    const int col = n0 + (lane & 31);
#pragma unroll 8
    for (int i = 0; i < 32; ++i) { const int kk = 2 * i + (lane >> 5); scr[kk * 33 + (lane & 31)] = (col < N) ? W[(size_t)(k0 + kk) * N + col] : 0.f; }
    LDS_WAIT(); asm volatile("" ::: "memory");
    const int c = lane & 7;
#pragma unroll
    for (int j = 0; j < 4; ++j) { const int n = (lane >> 3) + 8 * j; const LAS float* s = scr + (8 * c) * 33 + n;
        if (n0 + n < N) { u32x4 o; o.x = cvtpk(s[0 * 33], s[1 * 33]); o.y = cvtpk(s[2 * 33], s[3 * 33]); o.z = cvtpk(s[4 * 33], s[5 * 33]); o.w = cvtpk(s[6 * 33], s[7 * 33]);
            *(u32x4*)(WT + (size_t)map(n0 + n) * K + k0 + 8 * c) = o; } }
    LDS_WAIT(); asm volatile("" ::: "memory");
}
__device__ __forceinline__ void p0_prologue(Frame& F) {
    const int lane_ = lane_id(), tid_ = F.wave * 64 + lane_;
    if (F.bid < 96) {
        LAS float* sct = (LAS float*)F.lds;
        for (int e = tid_; e < 16 * 2048; e += NTHREADS) { const int b = e >> 11, k = e & 2047; sct[k * 16 + b] = siluf_(F.c[e]); }
        __syncthreads();
        const int col = 64 * F.bid + lane_;
        float acc[16];
#pragma unroll
        for (int b = 0; b < 16; ++b) acc[b] = 0.f;
        const float* wp = F.w_ada + (size_t)(256 * F.wave) * 6144 + col;
#pragma unroll 4
        for (int k = 0; k < 256; ++k) {
            const float wv = wp[(size_t)k * 6144];
            const LAS f32x4* s4 = (const LAS f32x4*)(sct + (256 * F.wave + k) * 16);
#pragma unroll
            for (int q = 0; q < 4; ++q) { const f32x4 sv = s4[q]; acc[4 * q] += sv.x * wv; acc[4 * q + 1] += sv.y * wv; acc[4 * q + 2] += sv.z * wv; acc[4 * q + 3] += sv.w * wv; }
        }
        __syncthreads();
        LAS float* red = (LAS float*)F.lds;
#pragma unroll
        for (int b = 0; b < 16; ++b) red[(F.wave * 16 + b) * 64 + lane_] = acc[b];
        __syncthreads();
        for (int o = tid_; o < 1024; o += NTHREADS) { const int b = o >> 6, cl = o & 63; float s = 0.f;
#pragma unroll
            for (int w = 0; w < 8; ++w) s += red[(w * 16 + b) * 64 + cl];
            WSP(float, WS_MOD)[b * 6144 + 64 * F.bid + cl] = s + F.b_ada[64 * F.bid + cl]; }
        __syncthreads();
    }
    LAS float* scr = (LAS float*)(F.lds + F.wave * 16384);
    const int gw = F.bid * NWAVES + F.wave, NGW = F.G * NWAVES;
    constexpr int I_WIN = 32 * 369, I_UP = 16 * 64, I_OUT = 32 * 64, I_C1 = 64 * 8, I_C2 = 4 * 4, I_B1 = 128;
    constexpr int NITEMS = I_WIN + 2 * I_UP + I_OUT + 2 * I_C1 + 2 * I_C2 + I_B1;
    for (int it = gw; it < NITEMS; it += NGW) {
        int r = it;
        if (r < I_WIN) { p0_transpose_item(F.w_in, 2048, IN_W, DOP(bf16_t, DO_WINT), scr, r, lane_, MapWin()); continue; } r -= I_WIN;
        if (r < I_UP) { p0_transpose_item(F.w_up_ret, 1024, 2048, WSP(bf16_t, WS_WUPR), scr, r, lane_, MapId()); continue; } r -= I_UP;
        if (r < I_UP) { p0_transpose_item(F.w_up_nsa, 1024, 2048, WSP(bf16_t, WS_WUPN), scr, r, lane_, MapId()); continue; } r -= I_UP;
        if (r < I_OUT) { p0_transpose_item(F.w_out, 2048, 2048, WSP(bf16_t, WS_WOUT), scr, r, lane_, MapId()); continue; } r -= I_OUT;
        if (r < I_C1) { p0_transpose_item(F.w_ck1, 4096, 256, WSP(bf16_t, WS_WCK1), scr, r, lane_, MapId()); continue; } r -= I_C1;
        if (r < I_C1) { p0_transpose_item(F.w_cv1, 4096, 256, WSP(bf16_t, WS_WCV1), scr, r, lane_, MapId()); continue; } r -= I_C1;
        if (r < I_C2) { p0_transpose_item(F.w_ck2, 256, 128, WSP(bf16_t, WS_WCK2), scr, r, lane_, MapId()); continue; } r -= I_C2;
        if (r < I_C2) { p0_transpose_item(F.w_cv2, 256, 128, WSP(bf16_t, WS_WCV2), scr, r, lane_, MapId()); continue; } r -= I_C2;
        {
            const int kv = r >> 6, kc = r & 63; const float* pe = kv ? F.pe_cv : F.pe_ck; const float* w1 = kv ? F.w_cv1 : F.w_ck1;
            f32x4 a = {0.f, 0.f, 0.f, 0.f};
            for (int k = 64 * kc; k < 64 * kc + 64; ++k) { const float p = pe[k]; const f32x4 w = *(const f32x4*)(w1 + (size_t)k * 256 + 4 * lane_); a += w * p; }
            *(f32x4*)(WSP(float, WS_B1P) + (size_t)(kv * 64 + kc) * 256 + 4 * lane_) = a;
        }
    }
}

__device__ __forceinline__ void p1_hnorm(Frame& F) {
    const int lane_ = lane_id();
    const int gw = F.bid * NWAVES + F.wave, NGW = F.G * NWAVES;
    const float* mod = WSP(float, WS_MOD);
    bf16_t* H = DOP(bf16_t, DO_H);
    for (int m = gw; m < MTOK; m += NGW) {
        const int b = m >> 11;
        const f32x4* xr = (const f32x4*)(F.x + (size_t)m * DM) + lane_;
        f32x4 v[8]; float s = 0.f;
#pragma unroll
        for (int j = 0; j < 8; ++j) { v[j] = xr[64 * j]; s += (v[j].x * v[j].x + v[j].y * v[j].y) + (v[j].z * v[j].z + v[j].w * v[j].w); }
        const float rs = 1.0f / sqrtf(wave_sum(s) * (1.f / DM) + EPS);
        u32x2* o8 = (u32x2*)(H + (size_t)m * DM) + lane_;
#pragma unroll
        for (int j = 0; j < 8; ++j) { const int c0 = 4 * lane_ + 256 * j;
            const f32x4 g = *(const f32x4*)(F.g_norm + c0), sh = *(const f32x4*)(mod + b * 6144 + c0), sc = *(const f32x4*)(mod + b * 6144 + 2048 + c0);
            const f32x4 h = (v[j] * rs) * g * (sc + 1.0f) + sh;
            u32x2 w; w.x = cvtpk(h.x, h.y); w.y = cvtpk(h.z, h.w); o8[64 * j] = w; }
    }
}

struct EpiProj {
    static constexpr bool PERM = true;
    unsigned char* ws; const int* pos;
    __device__ __forceinline__ bool keep(const pg8::Unit&) const { return false; }
    __device__ __forceinline__ void operator()(const f32x4 (&acc)[2][2][4][2], const pg8::Unit& u, int wr, int wc, int fr, int fq) const {
        const int pn = u.pn, row0 = u.pm * 256 + wr * 64 + fr, b = (u.pm * 256) >> 11;
        if (pn < 30) {
            size_t boff; int nh, h0, mode; float scl = 1.f;
            if (pn < 4) { boff = WS_RQ; nh = 8; h0 = 2 * pn; mode = 1; }
            else if (pn < 8) { boff = WS_RK; nh = 8; h0 = 2 * (pn - 4); mode = 1; scl = KSCALE_RET; }
            else if (pn < 12) { boff = WS_RV; nh = 8; h0 = 2 * (pn - 8); mode = 0; }
            else if (pn < 16) { boff = WS_RG; nh = 8; h0 = 2 * (pn - 12); mode = 2; }
            else if (pn < 20) { boff = WS_NQ; nh = 8; h0 = 2 * (pn - 16); mode = 1; scl = QSCALE; }
            else if (pn < 26) { const int q = pn - 20; boff = (q <= 2) ? WS_NKC + (size_t)q * 17 * MiB : WS_NKS + (size_t)(q - 2) * 16 * MiB; nh = 2; h0 = 0; mode = (pn == 22 || pn == 24) ? 1 : 0; }
            else { boff = WS_NG; nh = 8; h0 = 2 * (pn - 26); mode = 2; }
            bf16_t* base = (bf16_t*)(ws + boff);
            float inv[4];
#pragma unroll
            for (int i = 0; i < 4; ++i) inv[i] = rope_inv(16 * wc + 4 * fq + i);
#pragma unroll
            for (int ai = 0; ai < 2; ++ai)
#pragma unroll
                for (int m = 0; m < 4; ++m) {
                    const int row = row0 + ai * 128 + m * 16, s = row & 2047;
                    float cs[4], sn[4];
                    if (mode == 1) { const float p = (float)pos[row];
#pragma unroll
                        for (int i = 0; i < 4; ++i) sincos_rev(p * inv[i], cs[i], sn[i]); }
#pragma unroll
                    for (int bj = 0; bj < 2; ++bj) {
                        f32x4 v0 = acc[ai][bj][m][0], v1 = acc[ai][bj][m][1];
                        if (mode == 1) {
#pragma unroll
                            for (int i = 0; i < 4; ++i) { const float a = v0[i], c2 = v1[i]; v0[i] = (a * cs[i] - c2 * sn[i]) * scl; v1[i] = (c2 * cs[i] + a * sn[i]) * scl; } }
                        else if (mode == 2) {
#pragma unroll
                            for (int i = 0; i < 4; ++i) { v0[i] = siluf_(v0[i]); v1[i] = siluf_(v1[i]); } }
                        u32x4 w; w.x = cvtpk(v0[0], v0[1]); w.y = cvtpk(v0[2], v0[3]); w.z = cvtpk(v1[0], v1[1]); w.w = cvtpk(v1[2], v1[3]);
                        *(u32x4*)(base + ((size_t)(b * nh + h0 + bj) * SEQ + s) * 128 + 32 * wc + 8 * fq) = w;
                    }
                }
        } else if (pn < 46) {
            bf16_t* base = (bf16_t*)(ws + (pn < 38 ? WS_MA : WS_MB)); const int ct = (pn < 38 ? pn - 30 : pn - 38) * 256 + 32 * wc + 8 * fq;
#pragma unroll
            for (int ai = 0; ai < 2; ++ai)
#pragma unroll
                for (int m = 0; m < 4; ++m) { bf16_t* rp = base + (size_t)(row0 + ai * 128 + m * 16) * 2048 + ct;
#pragma unroll
                    for (int bj = 0; bj < 2; ++bj) { const f32x4 v0 = acc[ai][bj][m][0], v1 = acc[ai][bj][m][1];
                        u32x4 w; w.x = cvtpk(sigmoidf_(v0[0]), sigmoidf_(v0[1])); w.y = cvtpk(sigmoidf_(v0[2]), sigmoidf_(v0[3])); w.z = cvtpk(sigmoidf_(v1[0]), sigmoidf_(v1[1])); w.w = cvtpk(sigmoidf_(v1[2]), sigmoidf_(v1[3]));
                        *(u32x4*)(rp + bj * 128) = w; } }
        } else {
            if (wc == 0 && fq < 3) { float* gb = (float*)(ws + WS_GATES);
#pragma unroll
                for (int ai = 0; ai < 2; ++ai)
#pragma unroll
                    for (int m = 0; m < 4; ++m) { float* rp = gb + (size_t)(row0 + ai * 128 + m * 16) * 32 + 8 * fq;
#pragma unroll
                        for (int n = 0; n < 2; ++n) { const f32x4 v = acc[ai][0][m][n]; *(f32x4*)(rp + 4 * n) = (f32x4){sigmoidf_(v[0]), sigmoidf_(v[1]), sigmoidf_(v[2]), sigmoidf_(v[3])}; } } }
        }
    }
};

namespace att {
constexpr int SHM_K = 16384, SHM_V = 16384;
#define KSWZ(row, colB) ((row) * 256 + ((colB) ^ (((row) & 7) << 4)))
__device__ __forceinline__ int v_st(int k, int c) { const int kk = (k & ~0xC) | ((k & 4) << 1) | ((k & 8) >> 1); return ((kk >> 3) * 4 + (c >> 5)) * 512 + ((kk & 7) * 32 + (c & 31)) * 2; }
__device__ __forceinline__ int v_rd_base(int lane) { return ((lane & 3) << 3) | (((lane >> 2) & 3) << 6) | (((lane >> 4) & 1) << 5) | (((lane >> 5) & 1) << 8); }
constexpr int v_rd_off(int d0, int ks, int half) { return d0 * 512 + ks * 4096 + half * 2048; }
__device__ __forceinline__ int crow(int r, int hi) { return (r & 3) + 8 * (r >> 2) + 4 * hi; }
constexpr float THR = 8.f;
__device__ __forceinline__ void mask_tile(f32x16& p0, f32x16& p1, int dq, unsigned W) {
    const float NEG = -__builtin_inff();
#pragma unroll
    for (int r = 0; r < 16; ++r) {
        const int c = (r & 3) + 8 * (r >> 2);
        if ((unsigned)(dq - c) >= W) p0[r] = NEG;
        if ((unsigned)(dq - c - 32) >= W) p1[r] = NEG;
    }
}
__device__ __forceinline__ float half_swap_max(float v) { auto rr = __builtin_amdgcn_permlane32_swap(__float_as_uint(v), __float_as_uint(v), false, false); return fmaxf(__uint_as_float(rr[0]), __uint_as_float(rr[1])); }
__device__ __forceinline__ float half_swap_sum(float v) { auto rr = __builtin_amdgcn_permlane32_swap(__float_as_uint(v), __float_as_uint(v), false, false); return __uint_as_float(rr[0]) + __uint_as_float(rr[1]); }
__device__ __forceinline__ void partialSM(f32x16& p0, f32x16& p1, float& m_reg, float& alpha) {
    float pmax = p0[0];
#pragma unroll
    for (int r = 1; r < 16; ++r) pmax = fmaxf(pmax, p0[r]);
#pragma unroll
    for (int r = 0; r < 16; ++r) pmax = fmaxf(pmax, p1[r]);
    pmax = half_swap_max(pmax);
    float mn;
    if (__builtin_expect(__all((pmax - m_reg) <= THR), 1)) { mn = m_reg; alpha = 1.f; }
    else { mn = fmaxf(m_reg, pmax); alpha = __builtin_amdgcn_exp2f(m_reg - mn); m_reg = mn; }
#pragma unroll
    for (int r = 0; r < 16; ++r) { p0[r] = __builtin_amdgcn_exp2f(p0[r] - mn); p1[r] = __builtin_amdgcn_exp2f(p1[r] - mn); }
}
#define PK4(P, B_, OUT) do { unsigned a0 = cvtpk(P[B_+0], P[B_+1]), a1 = cvtpk(P[B_+2], P[B_+3]);                          \
        unsigned b0 = cvtpk(P[B_+4], P[B_+5]), b1 = cvtpk(P[B_+6], P[B_+7]);                                             \
        auto r0 = __builtin_amdgcn_permlane32_swap(a0, b0, false, false); auto r1 = __builtin_amdgcn_permlane32_swap(a1, b1, false, false); \
        u32x4 w = {r0[0], r1[0], r0[1], r1[1]}; OUT = __builtin_bit_cast(bf16x8, w); } while (0)
__device__ __forceinline__ void pack_p(const f32x16& p0, const f32x16& p1, bf16x8& pa0, bf16x8& pa1, bf16x8& pa2, bf16x8& pa3) {
    PK4(p0, 0, pa0); PK4(p0, 8, pa1); PK4(p1, 0, pa2); PK4(p1, 8, pa3);
}
__device__ __forceinline__ void finishSM(const f32x16& p0, const f32x16& p1, float alpha, float& l_reg, bf16x8& pa0, bf16x8& pa1, bf16x8& pa2, bf16x8& pa3) {
    float ps = 0;
#pragma unroll
    for (int r = 0; r < 16; ++r) ps += p0[r];
#pragma unroll
    for (int r = 0; r < 16; ++r) ps += p1[r];
    ps = half_swap_sum(ps);
    l_reg = l_reg * alpha + ps;
    pack_p(p0, p1, pa0, pa1, pa2, pa3);
}
__device__ __forceinline__ void qkt(f32x16& p0, f32x16& p1, const LAS unsigned char* kt, int r32, int hi, const bf16x8* qr) {
    p0 = f32x16{}; p1 = f32x16{};
    const LAS unsigned char* kb[4];
#pragma unroll
    for (int dd = 0; dd < 4; ++dd) kb[dd] = kt + KSWZ(r32, (dd * 16 + hi * 8) * 2);
#pragma unroll
    for (int d0 = 0; d0 < 8; ++d0) { const LAS unsigned char* a = kb[d0 & 3] + (d0 >> 2) * 128;
        const bf16x8 b0 = *(const LAS bf16x8*)(a);
        const bf16x8 b1 = *(const LAS bf16x8*)(a + 32 * 256);
        p0 = __builtin_amdgcn_mfma_f32_32x32x16_bf16(b0, qr[d0], p0, 0, 0, 0);
        p1 = __builtin_amdgcn_mfma_f32_32x32x16_bf16(b1, qr[d0], p1, 0, 0, 0); }
}
#define TRRD(dst, addr, off) asm volatile("ds_read_b64_tr_b16 %0, %1 offset:%2" : "=&v"(dst) : "v"(addr), "i"(off) : "memory")
#define PV_D0(oacc, vb, d0) do { s16x4 l0, l1, l2, l3, h0, h1, h2, h3; constexpr int b_ = att::v_rd_off(d0, 0, 0);   \
        TRRD(l0, vb, b_); TRRD(h0, vb, b_ + 2048); TRRD(l1, vb, b_ + 4096); TRRD(h1, vb, b_ + 6144); TRRD(l2, vb, b_ + 8192); TRRD(h2, vb, b_ + 10240); TRRD(l3, vb, b_ + 12288); TRRD(h3, vb, b_ + 14336); \
        asm volatile("s_waitcnt lgkmcnt(0)" ::: "memory"); SBAR();   \
        oacc = __builtin_amdgcn_mfma_f32_32x32x16_bf16(pa0, (bf16x8){l0[0], l0[1], l0[2], l0[3], h0[0], h0[1], h0[2], h0[3]}, oacc, 0, 0, 0);   \
        oacc = __builtin_amdgcn_mfma_f32_32x32x16_bf16(pa1, (bf16x8){l1[0], l1[1], l1[2], l1[3], h1[0], h1[1], h1[2], h1[3]}, oacc, 0, 0, 0);   \
        oacc = __builtin_amdgcn_mfma_f32_32x32x16_bf16(pa2, (bf16x8){l2[0], l2[1], l2[2], l2[3], h2[0], h2[1], h2[2], h2[3]}, oacc, 0, 0, 0);   \
        oacc = __builtin_amdgcn_mfma_f32_32x32x16_bf16(pa3, (bf16x8){l3[0], l3[1], l3[2], l3[3], h3[0], h3[1], h3[2], h3[3]}, oacc, 0, 0, 0); } while (0)
#define TRFRAG(dst, vb, d0, ks) do { s16x4 l_, h_; TRRD(l_, vb, att::v_rd_off(d0, ks, 0)); TRRD(h_, vb, att::v_rd_off(d0, ks, 1)); \
        asm volatile("s_waitcnt lgkmcnt(0)" ::: "memory"); SBAR(); dst = (bf16x8){l_[0], l_[1], l_[2], l_[3], h_[0], h_[1], h_[2], h_[3]}; } while (0)
}

namespace nsa {
constexpr int L_K = 0, L_V = 32768, L_TOT = 65536, L_WS = 131072, L_IMP = 133120, L_MSK = 141312, L_UNI = 141568;
__device__ __forceinline__ void load_tile_regs(const bf16_t* Kp, const bf16_t* Vp, int sr, int sc, bf16x8& k0, bf16x8& k1, bf16x8& v0, bf16x8& v1) {
    k0 = *(const bf16x8*)(Kp + (size_t)sr * 128 + sc); k1 = *(const bf16x8*)(Kp + (size_t)(32 + sr) * 128 + sc);
    v0 = *(const bf16x8*)(Vp + (size_t)sr * 128 + sc); v1 = *(const bf16x8*)(Vp + (size_t)(32 + sr) * 128 + sc);
}
__device__ __forceinline__ void finalize_branch(const f32x16 (&o)[4], LAS unsigned char* totw, LAS float* li_l, float f, int r32, int hi, bool first) {
    if (hi == 0) li_l[r32] = f;
    LDS_WAIT(); asm volatile("" ::: "memory");
#pragma unroll
    for (int r = 0; r < 16; ++r) { const int row = att::crow(r, hi); const float fr_ = li_l[row];
#pragma unroll
        for (int d0 = 0; d0 < 4; ++d0) { LAS bf16_t* p = (LAS bf16_t*)(totw + row * 256) + d0 * 32 + r32; float v = o[d0][r] * fr_;
            if (!first) v += bf2f(*p);
            *p = f2bf(v); } }
    LDS_WAIT(); asm volatile("" ::: "memory");
}
__device__ __forceinline__ void unit(Frame& F, int b, int g, int qt) {
    const int lane = lane_id(), wid = F.wave, tid = wid * 64 + lane, r32 = lane & 31, hi = lane >> 5, hd = r32 >> 3, qi = r32 & 7;
    const int t0 = 64 * qt, tl = 8 * wid + qi, t = t0 + tl;
    LAS unsigned char* L = F.lds;
    const unsigned lbase = (unsigned)(uintptr_t)L;
    LAS float* wsf = (LAS float*)(L + L_WS) + wid * 64; LAS float* li_l = wsf; LAS float* al_l = wsf + 32;
    LAS unsigned char* totw = L + L_TOT + wid * 8192;
    const int sr = tid >> 4, sc = (tid & 15) * 8, kws = KSWZ(sr, sc * 2), vst0 = att::v_st(sr, sc), vst1 = att::v_st(32 + sr, sc);
    const int vb0 = (int)(lbase + L_V) + att::v_rd_base(lane);
    __syncthreads();
    const bf16_t* qptr = WSP(bf16_t, WS_NQ) + ((size_t)(b * 8 + 4 * g + hd) * SEQ + t) * 128 + hi * 8;
    const float* gates = WSP(float, WS_GATES) + (size_t)(b * SEQ + t) * 32 + (4 * g + hd) * 3;
    f32x16 o[4]; bf16x8 pa0, pa1, pa2, pa3;
    unsigned msel, uni;
    {
        const int nct = (qt >= 16) ? 2 : 1;
        const float* kp = WSP(float, WS_KCP) + (size_t)((b * 2 + g) * 2 + 0) * 4 * 16384;
        const float* vp = kp + (size_t)4 * 16384;
        const int dlow = 16 * (sc >> 5) + 4 * ((sc >> 3) & 3);
        float inv[4];
#pragma unroll
        for (int i = 0; i < 4; ++i) inv[i] = rope_inv(dlow + i);
#pragma unroll 1
        for (int it = 0; it < 2 * nct; ++it) {
                const int c = it >> 1, hh = it & 1;
                const int n = 64 * c + 32 * hh + sr;
                f32x4 x1 = {0.f, 0.f, 0.f, 0.f}, x2 = x1, va = x1, vb = x1;
                if (n < NCMP) {
#pragma unroll
                    for (int p = 0; p < 4; ++p) { const float* kr = kp + (size_t)p * 16384 + n * 128; const float* vr = vp + (size_t)p * 16384 + n * 128;
                        x1 += *(const f32x4*)(kr + dlow); x2 += *(const f32x4*)(kr + dlow + 64); va += *(const f32x4*)(vr + sc); vb += *(const f32x4*)(vr + sc + 4); }
                    const float ps = (float)F.pos[b * SEQ + 16 * n + 31];
#pragma unroll
                    for (int i = 0; i < 4; ++i) { float cs, sn; sincos_rev(ps * inv[i], cs, sn); const float a = x1[i], c2 = x2[i]; x1[i] = a * cs - c2 * sn; x2[i] = c2 * cs + a * sn; }
                }
                u32x4 kw = {cvtpk(x1[0], x1[1]), cvtpk(x1[2], x1[3]), cvtpk(x2[0], x2[1]), cvtpk(x2[2], x2[3])};
                u32x4 vw = {cvtpk(va[0], va[1]), cvtpk(va[2], va[3]), cvtpk(vb[0], vb[1]), cvtpk(vb[2], vb[3])};
                *(LAS u32x4*)(L + L_K + c * att::SHM_K + kws + hh * 32 * 256) = kw;
                *(LAS u32x4*)(L + L_V + c * att::SHM_V + (hh ? vst1 : vst0)) = vw;
            }
        __syncthreads();
        f32x16 sA0, sA1, sB0, sB1;
        const int nv = t >= 31 ? ((t - 31) >> 4) + 1 : 0;
        bf16x8 qr[8];
#pragma unroll
        for (int d0 = 0; d0 < 8; ++d0) qr[d0] = *(const bf16x8*)(qptr + d0 * 16);
        att::qkt(sA0, sA1, L + L_K, r32, hi, qr); att::mask_tile(sA0, sA1, nv - 1 - 4 * hi, 0x40000000u);
        if (nct == 2) { att::qkt(sB0, sB1, L + L_K + att::SHM_K, r32, hi, qr); att::mask_tile(sB0, sB1, nv - 1 - 64 - 4 * hi, 0x40000000u); }
        else {
#pragma unroll
            for (int r = 0; r < 16; ++r) { sB0[r] = -__builtin_inff(); sB1[r] = -__builtin_inff(); } }
        float mx = -1e30f;
#pragma unroll
        for (int r = 0; r < 16; ++r) mx = fmaxf(fmaxf(mx, sA0[r]), fmaxf(sA1[r], fmaxf(sB0[r], sB1[r])));
        mx = att::half_swap_max(mx);
        float l = 0.f;
#pragma unroll
        for (int r = 0; r < 16; ++r) { sA0[r] = __builtin_amdgcn_exp2f(sA0[r] - mx); sA1[r] = __builtin_amdgcn_exp2f(sA1[r] - mx); sB0[r] = __builtin_amdgcn_exp2f(sB0[r] - mx); sB1[r] = __builtin_amdgcn_exp2f(sB1[r] - mx);
            l += (sA0[r] + sA1[r]) + (sB0[r] + sB1[r]); }
        l = att::half_swap_sum(l);
        const float rl = l > 0.f ? 1.f / l : 0.f;
        if (qt >= 16) {
            LAS float* Pw = (LAS float*)totw;
#pragma unroll
            for (int blk = 0; blk < 4; ++blk)
#pragma unroll
                for (int r = 0; r < 16; ++r) { float x = (blk == 0 ? sA0[r] : blk == 1 ? sA1[r] : blk == 2 ? sB0[r] : sB1[r]) * rl;
                    x += __shfl_xor(x, 8); x += __shfl_xor(x, 16);
                    if (hd == 0) Pw[qi * 128 + 32 * blk + att::crow(r, hi)] = x; }
        }
        bf16x8 pb0, pb1, pb2, pb3;
        att::pack_p(sA0, sA1, pa0, pa1, pa2, pa3); att::pack_p(sB0, sB1, pb0, pb1, pb2, pb3);
        asm volatile("" : "+v"(pa0), "+v"(pa1), "+v"(pa2), "+v"(pa3), "+v"(pb0), "+v"(pb1), "+v"(pb2), "+v"(pb3));
        if (qt >= 16) {
            LAS float* Pw = (LAS float*)totw;
            LAS float* impw = Pw + 1024;
            LDS_WAIT(); asm volatile("" ::: "memory");
            { const int q = lane >> 3, jb = lane & 7;
              const LAS float* pq = Pw + q * 128 + 16 * jb;
              float prev = (jb > 0) ? pq[-1] : 0.f;
              f32x4 im;
#pragma unroll
              for (int e = 0; e < 4; ++e) { const f32x4 x = *(const LAS f32x4*)(pq + 4 * e); im[e] = 0.5f * prev + (x.x + x.y) + (x.z + 0.5f * x.w); prev = x.w; }
              u32x4 key;
#pragma unroll
              for (int e = 0; e < 4; ++e) { const int j = 4 * jb + e; const bool cand = (j <= qt) && (j != 0) && (j != qt) && (j != qt - 1);
                  key[e] = cand ? ((__float_as_uint(im[e]) & ~31u) | (unsigned)(31 - j)) : 0u; }
              *(LAS u32x4*)((LAS unsigned*)impw + q * 32 + 4 * jb) = key;
              LDS_WAIT(); asm volatile("" ::: "memory");
              unsigned v[32];
#pragma unroll
              for (int k4 = 0; k4 < 8; ++k4) { const u32x4 x = *(const LAS u32x4*)((LAS unsigned*)impw + q * 32 + 4 * k4); v[4 * k4] = x.x; v[4 * k4 + 1] = x.y; v[4 * k4 + 2] = x.z; v[4 * k4 + 3] = x.w; }
              unsigned bits = 0;
#pragma unroll
              for (int e = 0; e < 4; ++e) { const int j = 4 * jb + e; const unsigned kj = key[e];
                  int rank = 0;
#pragma unroll
                  for (int k = 0; k < 32; ++k) rank += (v[k] > kj) ? 1 : 0;
                  const bool forced = (j == 0) || (j == qt) || (j == qt - 1);
                  const bool sel = (j <= qt) && (forced || rank < 13);
                  bits |= sel ? (1u << j) : 0u; }
              bits |= __shfl_xor(bits, 1); bits |= __shfl_xor(bits, 2); bits |= __shfl_xor(bits, 4);
              LAS unsigned* mskw = (LAS unsigned*)(L + L_MSK) + wid * 8;
              if (jb == 0) mskw[q] = bits;
              LDS_WAIT(); asm volatile("" ::: "memory");
              msel = mskw[qi]; }
            unsigned u = msel; u |= __shfl_xor(u, 1); u |= __shfl_xor(u, 2); u |= __shfl_xor(u, 4);
            if (lane == 0) ((LAS unsigned*)(L + L_UNI))[wid] = u;
        } else { msel = (2u << qt) - 1u; if (lane == 0) ((LAS unsigned*)(L + L_UNI))[wid] = msel; }
#pragma unroll
        for (int d0 = 0; d0 < 4; ++d0) o[d0] = f32x16{};
        PV_D0(o[0], vb0, 0); PV_D0(o[1], vb0, 1); PV_D0(o[2], vb0, 2); PV_D0(o[3], vb0, 3);
        if (nct == 2) { pa0 = pb0; pa1 = pb1; pa2 = pb2; pa3 = pb3; const int vb1 = vb0 + att::SHM_V;
            PV_D0(o[0], vb1, 0); PV_D0(o[1], vb1, 1); PV_D0(o[2], vb1, 2); PV_D0(o[3], vb1, 3); }
        finalize_branch(o, totw, li_l, gates[0] * rl, r32, hi, true);
    }
    __syncthreads();
    { uni = 0; const LAS unsigned* up = (const LAS unsigned*)(L + L_UNI);
#pragma unroll
      for (int w = 0; w < 8; ++w) uni |= up[w]; }
    uni = __builtin_amdgcn_readfirstlane(uni);
    bf16x8 qr[8];
#pragma unroll
    for (int d0 = 0; d0 < 8; ++d0) qr[d0] = *(const bf16x8*)(qptr + d0 * 16);
#pragma unroll 1
    for (int br = 1; br < 3; ++br) {
        const bf16_t* Kg = WSP(bf16_t, br == 1 ? WS_NKS : WS_NKW) + (size_t)(b * 2 + g) * SEQ * 128 + sc;
        const bf16_t* Vg = WSP(bf16_t, br == 1 ? WS_NVS : WS_NVW) + (size_t)(b * 2 + g) * SEQ * 128 + sc;
        const int jlo = (br == 1) ? 0 : (qt >= 8 ? qt - 8 : 0);
        float m_reg = -1e30f, l_reg = 0.f;
#pragma unroll
        for (int d0 = 0; d0 < 4; ++d0) o[d0] = f32x16{};
#pragma unroll 1
        for (int j = jlo; j <= qt; ++j) {
            if (br == 1 && !((uni >> j) & 1u)) continue;
            bf16x8 k0, k1, v0, v1;
            load_tile_regs(Kg + (size_t)(64 * j) * 128, Vg + (size_t)(64 * j) * 128, sr, 0, k0, k1, v0, v1);
            __syncthreads();
            *(LAS bf16x8*)(L + L_K + kws) = k0; *(LAS bf16x8*)(L + L_K + kws + 32 * 256) = k1;
            *(LAS bf16x8*)(L + L_V + vst0) = v0; *(LAS bf16x8*)(L + L_V + vst1) = v1;
            __syncthreads();
            f32x16 p0, p1; float alpha;
            att::qkt(p0, p1, L + L_K, r32, hi, qr);
            const unsigned W = (br == 1) ? (((msel >> j) & 1u) ? 0x40000000u : 0u) : 512u;
            att::mask_tile(p0, p1, t - 64 * j - 4 * hi, W);
            att::partialSM(p0, p1, m_reg, alpha);
            att::finishSM(p0, p1, alpha, l_reg, pa0, pa1, pa2, pa3);
            if (__any(alpha < 1.f)) { if (hi == 0) al_l[r32] = alpha; LDS_WAIT(); asm volatile("" ::: "memory");
#pragma unroll
                for (int r = 0; r < 16; ++r) { const float a = al_l[att::crow(r, hi)];
#pragma unroll
                    for (int d0 = 0; d0 < 4; ++d0) o[d0][r] *= a; }
                LDS_WAIT(); asm volatile("" ::: "memory"); }
            PV_D0(o[0], vb0, 0); PV_D0(o[1], vb0, 1); PV_D0(o[2], vb0, 2); PV_D0(o[3], vb0, 3);
        }
        finalize_branch(o, totw, li_l, l_reg > 0.f ? gates[br] / l_reg : 0.f, r32, hi, false);
    }
    { const bf16_t* NG = WSP(bf16_t, WS_NG); bf16_t* Y = DOP(bf16_t, DO_YNSA);
#pragma unroll
      for (int k = 0; k < 8; ++k) { const int id = lane + 64 * k, row = id >> 4, ch = id & 15, hd_ = row >> 3, tok = t0 + 8 * wid + (row & 7), head = 4 * g + hd_;
          const u32x4 tv = *(const LAS u32x4*)(totw + row * 256 + ch * 16);
          const u32x4 gv = *(const u32x4*)(NG + ((size_t)(b * 8 + head) * SEQ + tok) * 128 + 8 * ch);
          u32x4 ov;
#pragma unroll
          for (int e = 0; e < 4; ++e) ov[e] = cvtpk(bf_lo(tv[e]) * bf_lo(gv[e]), bf_hi(tv[e]) * bf_hi(gv[e]));
          *(u32x4*)(Y + (size_t)(b * SEQ + tok) * 1024 + head * 128 + 8 * ch) = ov; } }
}
}

namespace ret {
__device__ __forceinline__ float log2_gamma(int h) { return log2f(1.f - exp2f(-5.f - (float)h)); }
__device__ __forceinline__ void scan_unit(Frame& F, int b, int h, int dvh) {
    const int lane = lane_id(), wid = F.wave, tid = wid * 64 + lane, hi = lane >> 5, kt = wid & 3, vt = wid >> 2;
    LAS unsigned char* L = F.lds;
    const unsigned lbase = (unsigned)(uintptr_t)L;
    const int kb0 = (int)lbase + att::v_rd_base(lane), vb0 = kb0 + 32768;
    const int sr = tid >> 4, sc = (tid & 15) * 8;
    const float l2g = log2_gamma(h);
    const float cdecay = exp2f(l2g * 128.f);
    const bf16_t* Kg = WSP(bf16_t, WS_RK) + (size_t)(b * 8 + h) * SEQ * 128 + sc;
    const bf16_t* Vg = WSP(bf16_t, WS_RV) + (size_t)(b * 8 + h) * SEQ * 128 + sc;
    bf16_t* St = DOP(bf16_t, DO_STATES) + (size_t)(b * 8 + h) * 16 * 16384;
    f32x16 acc = f32x16{};
    const int dv = 64 * dvh + 32 * vt + (lane & 31);
#pragma unroll 1
    for (int n = 0; n < 16; ++n) {
        bf16x8 kr[4], vr[4];
#pragma unroll
        for (int q = 0; q < 4; ++q) { const size_t off = (size_t)(128 * n + sr + 32 * q) * 128; kr[q] = *(const bf16x8*)(Kg + off); vr[q] = *(const bf16x8*)(Vg + off); }
        { bf16_t* sp = St + (size_t)n * 16384 + (size_t)dv * 128 + 32 * kt + 4 * hi;
#pragma unroll
          for (int rg = 0; rg < 4; ++rg) { u32x2 w = {cvtpk(acc[4 * rg], acc[4 * rg + 1]), cvtpk(acc[4 * rg + 2], acc[4 * rg + 3])}; *(u32x2*)(sp + 8 * rg) = w; } }
        __syncthreads();
#pragma unroll
        for (int q = 0; q < 4; ++q) { const int m = sr + 32 * q; const float z = exp2f(l2g * (float)(127 - m));
            const u32x4 vv = __builtin_bit_cast(u32x4, vr[q]); u32x4 vz;
#pragma unroll
            for (int e = 0; e < 4; ++e) vz[e] = cvtpk(bf_lo(vv[e]) * z, bf_hi(vv[e]) * z);
            const int o_ = (q >> 1) * 16384 + att::v_st(sr + 32 * (q & 1), sc);
            *(LAS bf16x8*)(L + o_) = kr[q]; *(LAS u32x4*)(L + 32768 + o_) = vz; }
        __syncthreads();
        acc = acc * cdecay;
#pragma unroll
        for (int tk = 0; tk < 2; ++tk)
#pragma unroll
            for (int ks = 0; ks < 4; ++ks) { bf16x8 af, bfr;
                switch (kt) { case 0: TRFRAG(af, kb0 + tk * 16384, 0, ks); break; case 1: TRFRAG(af, kb0 + tk * 16384, 1, ks); break; case 2: TRFRAG(af, kb0 + tk * 16384, 2, ks); break; default: TRFRAG(af, kb0 + tk * 16384, 3, ks); break; }
                switch (2 * dvh + vt) { case 0: TRFRAG(bfr, vb0 + tk * 16384, 0, ks); break; case 1: TRFRAG(bfr, vb0 + tk * 16384, 1, ks); break; case 2: TRFRAG(bfr, vb0 + tk * 16384, 2, ks); break; default: TRFRAG(bfr, vb0 + tk * 16384, 3, ks); break; }
                acc = __builtin_amdgcn_mfma_f32_32x32x16_bf16(af, bfr, acc, 0, 0, 0); }
    }
    __syncthreads();
}
__device__ __forceinline__ void out_unit(Frame& F, int b, int h, int n) {
    const int lane = lane_id(), wid = F.wave, tid = wid * 64 + lane, r32 = lane & 31, hi = lane >> 5, rt = wid & 3, dvh = wid >> 2;
    LAS unsigned char* L = F.lds;
    const unsigned lbase = (unsigned)(uintptr_t)L;
    const int vb0 = (int)lbase + 32768 + att::v_rd_base(lane);
    const int sr = tid >> 4, sc = (tid & 15) * 8;
    const float l2g = log2_gamma(h);
    const size_t hb = (size_t)(b * 8 + h) * SEQ * 128 + (size_t)(128 * n) * 128;
    __syncthreads();
    { const bf16_t* Kg = WSP(bf16_t, WS_RK) + hb + sc; const bf16_t* Vg = WSP(bf16_t, WS_RV) + hb + sc;
#pragma unroll
      for (int q = 0; q < 4; ++q) { const size_t off = (size_t)(sr + 32 * q) * 128; const bf16x8 kk = *(const bf16x8*)(Kg + off), vv = *(const bf16x8*)(Vg + off);
          *(LAS bf16x8*)(L + (q >> 1) * 16384 + KSWZ(sr + 32 * (q & 1), sc * 2)) = kk;
          *(LAS bf16x8*)(L + 32768 + (q >> 1) * 16384 + att::v_st(sr + 32 * (q & 1), sc)) = vv; } }
    bf16x8 qr[8];
    { const bf16_t* q = WSP(bf16_t, WS_RQ) + hb + (size_t)(32 * rt + r32) * 128 + hi * 8;
#pragma unroll
      for (int d0 = 0; d0 < 8; ++d0) qr[d0] = *(const bf16x8*)(q + d0 * 16); }
    f32x16 o0 = f32x16{}, o1 = f32x16{};
    if (n > 0) {
        const bf16_t* sp = DOP(bf16_t, DO_STATES) + ((size_t)(b * 8 + h) * 16 + n) * 16384 + (size_t)(64 * dvh + r32) * 128 + hi * 8;
#pragma unroll
        for (int s = 0; s < 8; ++s) { const bf16x8 f0 = *(const bf16x8*)(sp + s * 16), f1 = *(const bf16x8*)(sp + 32 * 128 + s * 16);
            o0 = __builtin_amdgcn_mfma_f32_32x32x16_bf16(qr[s], f0, o0, 0, 0, 0); o1 = __builtin_amdgcn_mfma_f32_32x32x16_bf16(qr[s], f1, o1, 0, 0, 0); }
#pragma unroll
        for (int r = 0; r < 16; ++r) { const float xi = exp2f(l2g * (float)(32 * rt + att::crow(r, hi) + 1)); o0[r] *= xi; o1[r] *= xi; }
    }
    __syncthreads();
    const int c = 32 * rt + r32;
#pragma unroll
    for (int tk = 0; tk < 2; ++tk) {
        if (64 * tk > 32 * rt + 31) continue;
        f32x16 p0, p1; bf16x8 pa0, pa1, pa2, pa3;
        att::qkt(p0, p1, L + tk * 16384, r32, hi, qr);
#pragma unroll
        for (int r = 0; r < 16; ++r) { const int m0 = 64 * tk + att::crow(r, hi), d0_ = c - m0, d1_ = d0_ - 32;
            p0[r] = d0_ >= 0 ? p0[r] * exp2f(l2g * (float)d0_) : 0.f; p1[r] = d1_ >= 0 ? p1[r] * exp2f(l2g * (float)d1_) : 0.f; }
        att::pack_p(p0, p1, pa0, pa1, pa2, pa3);
        const int vb = vb0 + tk * 16384;
        if (dvh == 0) { PV_D0(o0, vb, 0); PV_D0(o1, vb, 1); } else { PV_D0(o0, vb, 2); PV_D0(o1, vb, 3); }
    }
    LAS float* ost = (LAS float*)(L + 65536);
#pragma unroll
    for (int r = 0; r < 16; ++r) { const int row = 32 * rt + att::crow(r, hi); ost[row * 128 + 64 * dvh + r32] = o0[r]; ost[row * 128 + 64 * dvh + 32 + r32] = o1[r]; }
    __syncthreads();
    { const int row = tid >> 2, q4 = tid & 3;
      f32x4 v[8]; float s = 0.f;
#pragma unroll
      for (int j = 0; j < 8; ++j) { v[j] = *(const LAS f32x4*)(ost + row * 128 + 32 * q4 + 4 * j); s += (v[j].x + v[j].y) + (v[j].z + v[j].w); }
      s += __shfl_xor(s, 1); s += __shfl_xor(s, 2);
      const float mean = s * (1.f / 128.f); float qv = 0.f;
#pragma unroll
      for (int j = 0; j < 8; ++j) { v[j] = v[j] - mean; qv += (v[j].x * v[j].x + v[j].y * v[j].y) + (v[j].z * v[j].z + v[j].w * v[j].w); }
      qv += __shfl_xor(qv, 1); qv += __shfl_xor(qv, 2);
      const float rs = 1.0f / sqrtf(qv * (1.f / 128.f) + EPS);
      const bf16_t* rg = WSP(bf16_t, WS_RG) + hb + (size_t)row * 128 + 32 * q4;
      const float* gr = F.g_ret + h * 128 + 32 * q4;
      bf16_t* y = DOP(bf16_t, DO_YRET) + (size_t)(b * SEQ + 128 * n + row) * 1024 + h * 128 + 32 * q4;
#pragma unroll
      for (int j2 = 0; j2 < 4; ++j2) { const u32x4 gv = *(const u32x4*)(rg + 8 * j2); const f32x4 ga = *(const f32x4*)(gr + 8 * j2), gb = *(const f32x4*)(gr + 8 * j2 + 4);
          const f32x4 a = v[2 * j2] * rs * ga, c2 = v[2 * j2 + 1] * rs * gb;
          u32x4 ov = {cvtpk(a.x * bf_lo(gv[0]), a.y * bf_hi(gv[0])), cvtpk(a.z * bf_lo(gv[1]), a.w * bf_hi(gv[1])), cvtpk(c2.x * bf_lo(gv[2]), c2.y * bf_hi(gv[2])), cvtpk(c2.z * bf_lo(gv[3]), c2.w * bf_hi(gv[3]))};
          *(u32x4*)(y + 8 * j2) = ov; } }
}
}

namespace cmpr {
#define CSWZ(row, ch) ((row) * 128 + ((((ch) ^ ((row) & 7))) << 4))
__device__ __forceinline__ void unit(Frame& F, int gi, int cc) {
    const int lane = lane_id(), wid = F.wave, tid = wid * 64 + lane, r32 = lane & 31, hi = lane >> 5, rt = wid & 3, ct = wid >> 2;
    const int kv = gi & 1, bg = gi >> 1;
    LAS unsigned char* L = F.lds;
    const bf16_t* A = WSP(bf16_t, kv ? WS_NVC : WS_NKC) + (size_t)bg * SEQ * 128;
    const bf16_t* Bw = WSP(bf16_t, kv ? WS_WCV1 : WS_WCK1) + (size_t)(64 * cc) * 4096;
    const int lr = tid >> 3, lc = tid & 7;
    f32x16 acc = f32x16{};
    __syncthreads();
#pragma unroll 1
    for (int k0 = 0; k0 < 4096; k0 += 64) {
        const bf16x8 a0 = *(const bf16x8*)(A + (size_t)lr * 2048 + k0 + 8 * lc), a1 = *(const bf16x8*)(A + (size_t)(lr + 64) * 2048 + k0 + 8 * lc);
        const bf16x8 b0 = *(const bf16x8*)(Bw + (size_t)lr * 4096 + k0 + 8 * lc);
        __syncthreads();
        *(LAS bf16x8*)(L + CSWZ(lr, lc)) = a0; *(LAS bf16x8*)(L + CSWZ(lr + 64, lc)) = a1; *(LAS bf16x8*)(L + 16384 + CSWZ(lr, lc)) = b0;
        __syncthreads();
#pragma unroll
        for (int s = 0; s < 4; ++s) { const bf16x8 af = *(const LAS bf16x8*)(L + CSWZ(32 * rt + r32, 2 * s + hi)), bfr = *(const LAS bf16x8*)(L + 16384 + CSWZ(32 * ct + r32, 2 * s + hi));
            acc = __builtin_amdgcn_mfma_f32_32x32x16_bf16(af, bfr, acc, 0, 0, 0); }
    }
    { const int hid = 64 * cc + 32 * ct + r32; float b1 = 0.f; const float* bp = WSP(float, WS_B1P) + (size_t)kv * 64 * 256 + hid;
#pragma unroll 8
      for (int kc = 0; kc < 64; ++kc) b1 += bp[kc * 256];
#pragma unroll
      for (int r = 0; r < 16; ++r) { const int row = 32 * rt + att::crow(r, hi), col = 32 * ct + r32;
          *((LAS bf16_t*)(L + 24576 + CSWZ(row, col >> 3)) + (col & 7)) = f2bf(siluf_(acc[r] + b1)); } }
    __syncthreads();
    { const bf16_t* W2 = WSP(bf16_t, kv ? WS_WCV2 : WS_WCK2) + 64 * cc + hi * 8;
      f32x16 c0 = f32x16{}, c1 = f32x16{};
#pragma unroll
      for (int s = 0; s < 4; ++s) { const bf16x8 af = *(const LAS bf16x8*)(L + 24576 + CSWZ(32 * rt + r32, 2 * s + hi));
          const bf16x8 f0 = *(const bf16x8*)(W2 + (size_t)(64 * ct + r32) * 256 + 16 * s), f1 = *(const bf16x8*)(W2 + (size_t)(64 * ct + 32 + r32) * 256 + 16 * s);
          c0 = __builtin_amdgcn_mfma_f32_32x32x16_bf16(af, f0, c0, 0, 0, 0); c1 = __builtin_amdgcn_mfma_f32_32x32x16_bf16(af, f1, c1, 0, 0, 0); }
      float* op = WSP(float, WS_KCP) + ((size_t)gi * 4 + cc) * 16384;
#pragma unroll
      for (int r = 0; r < 16; ++r) { const int row = 32 * rt + att::crow(r, hi); op[row * 128 + 64 * ct + r32] = c0[r]; op[row * 128 + 64 * ct + 32 + r32] = c1[r]; } }
}
}

struct EpiMerge {
    static constexpr bool PERM = true;
    const bf16_t* MA; const bf16_t* MB; bf16_t* OUT;
    __device__ __forceinline__ bool keep(const pg8::Unit& u) const { return u.sel == 0; }
    __device__ __forceinline__ void operator()(f32x4 (&acc)[2][2][4][2], const pg8::Unit& u, int wr, int wc, int fr, int fq) const {
        const int row0 = u.pm * 256 + wr * 64 + fr, col0 = u.pn * 256 + 32 * wc + 8 * fq;
#pragma unroll
        for (int ai = 0; ai < 2; ++ai)
#pragma unroll
            for (int m = 0; m < 4; ++m) { const size_t ro = (size_t)(row0 + ai * 128 + m * 16) * 2048 + col0;
#pragma unroll
                for (int bj = 0; bj < 2; ++bj) {
                    const u32x4 sb = *(const u32x4*)(MB + ro + bj * 128);
                    if (u.sel == 0) { const u32x4 sa = *(const u32x4*)(MA + ro + bj * 128);
#pragma unroll
                        for (int e = 0; e < 4; ++e) { const float r0 = bf_lo(sa[e]) * __builtin_amdgcn_rcpf(fmaxf(bf_lo(sb[e]), 1e-30f)), r1 = bf_hi(sa[e]) * __builtin_amdgcn_rcpf(fmaxf(bf_hi(sb[e]), 1e-30f));
                            acc[ai][bj][m][e >> 1][2 * (e & 1)] *= r0; acc[ai][bj][m][e >> 1][2 * (e & 1) + 1] *= r1; } }
                    else { u32x4 w;
#pragma unroll
                        for (int e = 0; e < 4; ++e) w[e] = cvtpk(acc[ai][bj][m][e >> 1][2 * (e & 1)] * fmaxf(bf_lo(sb[e]), 1e-30f), acc[ai][bj][m][e >> 1][2 * (e & 1) + 1] * fmaxf(bf_hi(sb[e]), 1e-30f));
                        *(u32x4*)(OUT + ro + bj * 128) = w; }
                } }
    }
};
struct EpiOut {
    static constexpr bool PERM = false;
    const float* x; const float* mod; float* out; float* rowsq;
    __device__ __forceinline__ bool keep(const pg8::Unit&) const { return false; }
    __device__ __forceinline__ void operator()(const f32x4 (&acc)[2][2][4][2], const pg8::Unit& u, int wr, int wc, int fr, int fq) const {
        const int row0 = u.pm * 256 + wr * 64 + fr, col0 = u.pn * 256 + 32 * wc + 4 * fq, b = (u.pm * 256) >> 11;
        f32x4 gt[2][2];
#pragma unroll
        for (int bj = 0; bj < 2; ++bj)
#pragma unroll
            for (int n = 0; n < 2; ++n) gt[bj][n] = *(const f32x4*)(mod + b * 6144 + 4096 + col0 + bj * 128 + n * 16);
#pragma unroll
        for (int ai = 0; ai < 2; ++ai)
#pragma unroll
            for (int m = 0; m < 4; ++m) { const int row = row0 + ai * 128 + m * 16; const size_t ro = (size_t)row * 2048 + col0; float s = 0.f;
#pragma unroll
                for (int bj = 0; bj < 2; ++bj)
#pragma unroll
                    for (int n = 0; n < 2; ++n) { const f32x4 xv = *(const f32x4*)(x + ro + bj * 128 + n * 16); const f32x4 y = xv + gt[bj][n] * acc[ai][bj][m][n];
                        *(f32x4*)(out + ro + bj * 128 + n * 16) = y; s += (y.x * y.x + y.y * y.y) + (y.z * y.z + y.w * y.w); }
                s += __shfl_xor(s, 16); s += __shfl_xor(s, 32);
                if (fq == 0) rowsq[(size_t)(u.pn * 4 + wc) * MTOK + row] = s; }
    }
};
__device__ __forceinline__ void p7_final(Frame& F) {
    const int lane_ = lane_id();
    const int gw = F.bid * NWAVES + F.wave, NGW = F.G * NWAVES;
    const float* rowsq = WSP(float, WS_ROWSQ);
    for (int m = gw; m < MTOK; m += NGW) {
        float s = (lane_ < 32) ? rowsq[(size_t)lane_ * MTOK + m] : 0.f;
        s = wave_sum(s);
        const float rs = 1.0f / sqrtf(s * (1.f / DM) + EPS);
        f32x4* yr = (f32x4*)(F.out + (size_t)m * DM) + lane_;
#pragma unroll
        for (int j = 0; j < 8; ++j) { const f32x4 g = *(const f32x4*)(F.g_final + 4 * lane_ + 256 * j); yr[64 * j] = yr[64 * j] * rs * g; }
    }
}

#define XB_TMO      128
#define XB_XCNT(j)  (256  + 64 * (j))
#define XB_XSUB(j)  (1280 + 64 * (j))
#define XB_XGEN(j)  (2304 + 64 * (j))
#define XB_TOP      3328
#define XB_TOPGEN   3392
#define XCD_BAR_WORDS 3456
#define XB_SPIN_CAP (1u << 18)

__device__ __forceinline__ unsigned xb_ld(unsigned* p)              { return __hip_atomic_load(p, __ATOMIC_RELAXED, __HIP_MEMORY_SCOPE_AGENT); }
__device__ __forceinline__ unsigned xb_add(unsigned* p, unsigned v) { return __hip_atomic_fetch_add(p, v, __ATOMIC_RELAXED, __HIP_MEMORY_SCOPE_AGENT); }
__device__ __forceinline__ unsigned xb_xcc_id() { return (unsigned)__builtin_amdgcn_s_getreg((3 << 11) | 20) & 0xFu; }
#define XB_SPIN(cond, bar) do { unsigned _sp = 0; while (cond) { __builtin_amdgcn_s_sleep(1); \
    if ((++_sp & 255u) == 0u) { if (xb_ld(&(bar)[XB_TMO])) break; if (_sp > XB_SPIN_CAP) { atomicAdd(&(bar)[XB_TMO], 1u); break; } } } } while (0)

struct XcdBarrier {
    unsigned* bar; unsigned x;
    volatile LAS unsigned* st;
};

__device__ __forceinline__ XcdBarrier xcd_barrier_post(unsigned* bar, volatile LAS unsigned* st, bool leader) {
    XcdBarrier b; b.bar = bar; b.x = xb_xcc_id(); b.st = st;
    if (leader) (void)xb_add(&bar[XB_XCNT(b.x)], 1u);
    return b;
}
__device__ __forceinline__ void xcd_barrier_complete(unsigned* bar, unsigned x, unsigned& nloc, unsigned& nx) {
    const unsigned G = gridDim.x * gridDim.y * gridDim.z;
    unsigned sum, cnt, mine, sp = 0u;
    for (;;) {
        sum = 0u; cnt = 0u; mine = 0u;
#pragma unroll
        for (unsigned j = 0; j < 16; ++j) { const unsigned c = xb_ld(&bar[XB_XCNT(j)]); sum += c; cnt += (c > 0u) ? 1u : 0u; mine = (j == x) ? c : mine; }
        if (sum == G) break;
        __builtin_amdgcn_s_sleep(1);
        if ((++sp & 255u) == 0u) { if (xb_ld(&bar[XB_TMO])) break; if (sp > XB_SPIN_CAP) { atomicAdd(&bar[XB_TMO], 1u); break; } }
    }
    nloc = mine > 0u ? mine : 1u; nx = cnt > 0u ? cnt : 1u;
}

__device__ __forceinline__ void xcd_barrier(const XcdBarrier& b, bool leader) {
    asm volatile("s_waitcnt vmcnt(0)" ::: "memory");
    __syncthreads();
    if (leader) {
        unsigned* bar = b.bar;
        __builtin_amdgcn_s_waitcnt(0);
        unsigned nloc = b.st[0], nx = b.st[1];
        if (nloc == 0u) { xcd_barrier_complete(bar, b.x, nloc, nx); b.st[0] = nloc; b.st[1] = nx; }
        const unsigned old = xb_add(&bar[XB_XSUB(b.x)], 1u);
        const unsigned gen = old / nloc;
        if (old + 1u == (gen + 1u) * nloc) {
            __builtin_amdgcn_fence(__ATOMIC_RELEASE, "agent");
            asm volatile("s_waitcnt vmcnt(0)" ::: "memory");
            const unsigned og = xb_add(&bar[XB_TOP], 1u);
            const unsigned tg = og / nx;
            if (og + 1u == (tg + 1u) * nx) xb_add(&bar[XB_TOPGEN], 1u);
            else XB_SPIN(xb_ld(&bar[XB_TOPGEN]) == tg, bar);
            __builtin_amdgcn_fence(__ATOMIC_ACQUIRE, "agent");
            xb_add(&bar[XB_XGEN(b.x)], 1u);
            asm volatile("s_waitcnt vmcnt(0)" ::: "memory");
        } else {
            XB_SPIN(xb_ld(&bar[XB_XGEN(b.x)]) == gen, bar);
            __builtin_amdgcn_fence(__ATOMIC_ACQUIRE, "agent");
            asm volatile("s_waitcnt vmcnt(0)" ::: "memory");
        }
    }
    __syncthreads();
}

__global__ void __launch_bounds__(NTHREADS, 2) fwd_kernel(Args args) {
    extern __shared__ __attribute__((aligned(16))) unsigned char lds_raw[];
    cg::grid_group grid = cg::this_grid();
    Frame F;
    F.lds = (LAS unsigned char*)lds_raw;
    F.wave = __builtin_amdgcn_readfirstlane(threadIdx.x >> 6); F.G = gridDim.x; F.bid = blockIdx.x;
    F.x = (const float*)args.in[0]; F.c = (const float*)args.in[1]; F.pos = (const int*)args.in[2];
    F.w_ada = (const float*)args.in[3]; F.b_ada = (const float*)args.in[4]; F.g_norm = (const float*)args.in[5]; F.w_in = (const float*)args.in[6];
    F.g_ret = (const float*)args.in[7]; F.w_ck1 = (const float*)args.in[8]; F.w_ck2 = (const float*)args.in[9]; F.pe_ck = (const float*)args.in[10];
    F.w_cv1 = (const float*)args.in[11]; F.w_cv2 = (const float*)args.in[12]; F.pe_cv = (const float*)args.in[13];
    F.w_up_ret = (const float*)args.in[14]; F.w_up_nsa = (const float*)args.in[15]; F.w_out = (const float*)args.in[16]; F.g_final = (const float*)args.in[17];
    F.out = args.out; F.ws = args.ws; F.dob = (unsigned char*)args.out;
    const int lo = args.ph_lo, hi = args.ph_hi;
    volatile LAS unsigned* MISC = (volatile LAS unsigned*)(F.lds + LDS_BYTES - 256);
    if (threadIdx.x < 64) MISC[threadIdx.x] = 0u;
    __syncthreads();
    XcdBarrier bar = xcd_barrier_post((unsigned*)(F.ws + WS_CTL) + 4096, MISC + 8, threadIdx.x == 0);
#ifdef PH_ONLY
#define IN(k) ((k) == PH_ONLY && lo <= (k) && (k) < hi)
#else
#define IN(k) (lo <= (k) && (k) < hi)
#endif
#define SEAM(k) do { if (IN(k) && IN((k) + 1)) { if ((k) == 0) grid.sync(); else xcd_barrier(bar, F.wave == 0 && lane_id() == 0); } } while (0)
    if (IN(0)) { p0_prologue(F); } SEAM(0);
    if (IN(1)) { p1_hnorm(F); } SEAM(1);
    if (IN(2)) {
        pg8::Gemm g{DOP(bf16_t, DO_H), DOP(bf16_t, DO_WINT), nullptr, nullptr, MTOK, IN_WP, DM};
        pg8::StaticOrder<1> S; S.init(MTOK, IN_WP, F.G, F.bid);
        EpiProj E{F.ws, F.pos};
        pg8::gemm_phase<EpiProj, pg8::StaticOrder<1>>(F.lds, g, S, E, F.wave);
    } SEAM(2);
    if (IN(3)) {
        for (int u = F.bid; u < 256; u += F.G) ret::scan_unit(F, u >> 4, (u >> 1) & 7, u & 1);
        for (int u = F.bid; u < 256; u += F.G) cmpr::unit(F, u >> 2, u & 3);
    } SEAM(3);
    if (IN(4)) {
#ifndef NO_NSA
        for (int v = F.bid; v < 256; v += F.G) { const int bg = v >> 3, s = v & 7;
#pragma unroll 1
            for (int i = 0; i < 4; ++i) { const int qt = (i == 0) ? 31 - s : (i == 1) ? 16 + s : (i == 2) ? 15 - s : s; nsa::unit(F, bg >> 1, bg & 1, qt); } }
#endif
#ifndef NO_RETOUT
#pragma unroll 1
        for (int u = F.bid; u < 2048; u += F.G) ret::out_unit(F, u >> 7, (u >> 4) & 7, u & 15);
#endif
    } SEAM(4);
    if (IN(5)) {
        pg8::Gemm g{DOP(bf16_t, DO_YRET), WSP(bf16_t, WS_WUPR), DOP(bf16_t, DO_YNSA), WSP(bf16_t, WS_WUPN), MTOK, DM, 1024};
        pg8::StaticOrder<2> S; S.init(MTOK, DM, F.G, F.bid);
        EpiMerge E{WSP(bf16_t, WS_MA), WSP(bf16_t, WS_MB), WSP(bf16_t, WS_MERGED)};
        pg8::gemm_phase<EpiMerge, pg8::StaticOrder<2>>(F.lds, g, S, E, F.wave);
    } SEAM(5);
    if (IN(6)) {
        pg8::Gemm g{WSP(bf16_t, WS_MERGED), WSP(bf16_t, WS_WOUT), nullptr, nullptr, MTOK, DM, DM};
        pg8::StaticOrder<1> S; S.init(MTOK, DM, F.G, F.bid);
        EpiOut E{F.x, WSP(float, WS_MOD), F.out, WSP(float, WS_ROWSQ)};
        pg8::gemm_phase<EpiOut, pg8::StaticOrder<1>>(F.lds, g, S, E, F.wave);
    } SEAM(6);
    if (IN(7)) { p7_final(F); }
#undef IN
#undef SEAM
}

#ifndef MK_N_LAUNCHES
#define MK_N_LAUNCHES 1
#endif
extern "C" void kernel_launch(void* const* d_in, const int* in_sizes, int n_in, void* d_out, int out_size, void* d_ws, size_t ws_size, hipStream_t stream) {
    static int grid = 0;
    if (grid == 0) {
        if (n_in != 18 || in_sizes[0] != MTOK * DM || out_size != MTOK * DM || ws_size < WS_END) { fprintf(stderr, "kernel_launch: unexpected shapes (n_in %d, in0 %d, out %d, ws %zu)\n", n_in, n_in > 0 ? in_sizes[0] : -1, out_size, ws_size); grid = -1; return; }
        int dev = 0, cus = 0, per_cu = 0;
        if (hipGetDevice(&dev) != hipSuccess || hipDeviceGetAttribute(&cus, hipDeviceAttributeMultiprocessorCount, dev) != hipSuccess) { grid = -1; return; }
        if (hipFuncSetAttribute((const void*)fwd_kernel, hipFuncAttributeMaxDynamicSharedMemorySize, LDS_BYTES) != hipSuccess) { fprintf(stderr, "kernel_launch: hipFuncSetAttribute failed\n"); grid = -1; return; }
        if (hipOccupancyMaxActiveBlocksPerMultiprocessor(&per_cu, (const void*)fwd_kernel, NTHREADS, LDS_BYTES) != hipSuccess || per_cu < 1) { fprintf(stderr, "kernel_launch: occupancy query says %d\n", per_cu); (void)hipGetLastError(); per_cu = 1; }
        grid = cus;
        if (grid > 256) grid = 256;
    }
    if (grid < 0) return;
    (void)hipMemsetAsync((char*)d_ws + WS_CTL, 0, CTL_BYTES, stream);
    Args a{};
    for (int i = 0; i < 18; ++i) a.in[i] = d_in[i];
    a.out = (float*)d_out; a.ws = (unsigned char*)d_ws;
#if MK_N_LAUNCHES == 1
    a.ph_lo = 0; a.ph_hi = 8;
    void* kargs[] = {&a};
    hipError_t e = hipLaunchCooperativeKernel((const void*)fwd_kernel, dim3(grid), dim3(NTHREADS), kargs, LDS_BYTES, stream);
    if (e != hipSuccess) fprintf(stderr, "cooperative launch failed: %s (grid %d)\n", hipGetErrorString(e), grid);
#else
    for (int p = 0; p < 8; ++p) { a.ph_lo = p; a.ph_hi = p + 1; hipLaunchKernelGGL(fwd_kernel, dim3(grid), dim3(NTHREADS), LDS_BYTES, stream, a); }
#endif
}
```
